# Optimizing an MI355X kernel written in HIP

```python
import jax, jax.numpy as jnp
from jax import lax
import numpy as np

D_MODEL = 1024
BATCH = 8
SEQ = 2048
DEPTH = 2

CHUNK = 64
Q_BLOCK = 128
A_HEADS = 8
A_HEAD_DIM = D_MODEL // 16
A_WIDTH = A_HEADS * A_HEAD_DIM
POOL_WINDOWS = (2, 4, 8, 16)
POOL_GROUPS = len(POOL_WINDOWS)
POOL_WIDTH = D_MODEL // 4
POOL_GROUP_DIM = POOL_WIDTH // POOL_GROUPS
CONV_WIDTH = D_MODEL // 4
CONV_K = 3
N_BRANCH = 3
MIX_WIDTH = A_WIDTH + POOL_WIDTH + CONV_WIDTH
D_FF = 4 * D_MODEL
RMS_EPS = 1e-6
NEG_INF = -1e30
IN_COLS = 3 * A_WIDTH + A_HEADS + POOL_WIDTH + 3 * CONV_WIDTH + N_BRANCH * D_MODEL

kernel_name = 'hybrid_fox_pool_conv_block'


def rmsnorm(x, g):
    xf = x.astype(jnp.float32)
    y = xf * lax.rsqrt(jnp.mean(xf * xf, axis=-1, keepdims=True) + RMS_EPS)
    return (y * g.astype(jnp.float32)).astype(x.dtype)


def forgetting_attention(q, k, v, f_logit):
    b, s, h, dh = q.shape
    q = q.transpose(0, 2, 1, 3)
    k = k.transpose(0, 2, 1, 3)
    v = v.transpose(0, 2, 1, 3)
    log_f = jax.nn.log_sigmoid(f_logit.astype(jnp.float32))
    cum_f = jnp.cumsum(log_f, axis=1).transpose(0, 2, 1)
    scale = dh ** -0.5
    outs = []
    for i in range(s // Q_BLOCK):
        qs, qe = i * Q_BLOCK, (i + 1) * Q_BLOCK
        qb = q[:, :, qs:qe]
        kb = k[:, :, :qe]
        vb = v[:, :, :qe]
        logits = jnp.einsum('bhqd,bhkd->bhqk', qb, kb).astype(jnp.float32) * scale
        logits = logits + cum_f[:, :, qs:qe, None] - cum_f[:, :, None, :qe]
        causal = jnp.arange(qs, qe)[:, None] >= jnp.arange(qe)[None, :]
        logits = jnp.where(causal[None, None], logits, NEG_INF)
        p = jax.nn.softmax(logits, axis=-1).astype(v.dtype)
        outs.append(jnp.einsum('bhqk,bhkd->bhqd', p, vb))
    o = jnp.concatenate(outs, axis=2)
    return o.transpose(0, 2, 1, 3).reshape(b, s, h * dh)


def pool_mixer(u, w_pool, pool_scale):
    b, s, _ = u.shape
    uf = u.astype(jnp.float32)
    cs = jnp.cumsum(uf, axis=1)
    groups = []
    for g, w in enumerate(POOL_WINDOWS):
        sl = slice(g * POOL_GROUP_DIM, (g + 1) * POOL_GROUP_DIM)
        cs_g = cs[..., sl]
        lagged = jnp.pad(cs_g, ((0, 0), (w, 0), (0, 0)))[:, :s]
        count = jnp.minimum(jnp.arange(1, s + 1, dtype=jnp.float32), float(w))
        groups.append((cs_g - lagged) / count[None, :, None] - uf[..., sl])
    p = jnp.stack(groups, axis=2).astype(u.dtype)
    y = jnp.einsum('bsgc,gcd->bsgd', p, w_pool).reshape(b, s, POOL_WIDTH)
    return y * pool_scale


def short_conv(h, b_gate, c_gate, conv_w):
    u = c_gate * h
    y = lax.conv_general_dilated(
        u, conv_w[:, None, :].astype(u.dtype), window_strides=(1,), padding=[(CONV_K - 1, 0)],
        dimension_numbers=('NWC', 'WIO', 'NWC'), feature_group_count=CONV_WIDTH)
    return b_gate * y


def hybrid_layer(x, c, w_ada, b_ada, g_mix_pre, g_mix_post, g_ff_pre, g_ff_post, w_in, b_f,
                 w_pool, pool_scale, conv_w, w_branch, w_out, w_ff1, w_ff2):
    b, s, d = x.shape
    mod = jax.nn.silu(c) @ w_ada + b_ada
    shift_m, scale_m, gate_m, shift_f, scale_f, gate_f = jnp.split(mod, 6, axis=-1)

    h = rmsnorm(x, g_mix_pre) * (1.0 + scale_m[:, None]) + shift_m[:, None]
    z = h @ w_in
    sizes = [A_WIDTH, A_WIDTH, A_WIDTH, A_HEADS, POOL_WIDTH, CONV_WIDTH, CONV_WIDTH, CONV_WIDTH]
    cuts = [int(v) for v in np.cumsum(sizes)]
    q, k, v, fl, pu, ch, cb, cc, gl = jnp.split(z, cuts, axis=-1)
    heads = (b, s, A_HEADS, A_HEAD_DIM)
    br_a = forgetting_attention(q.reshape(heads), k.reshape(heads), v.reshape(heads), fl + b_f)
    br_b = pool_mixer(pu, w_pool, pool_scale)
    br_c = short_conv(ch, cb, cc, conv_w)
    gates = jax.nn.sigmoid(gl).reshape(b, s, N_BRANCH, d)
    wa = w_branch[:A_WIDTH]
    wb = w_branch[A_WIDTH:A_WIDTH + POOL_WIDTH]
    wc = w_branch[A_WIDTH + POOL_WIDTH:]
    merged = gates[:, :, 0] * (br_a @ wa) + gates[:, :, 1] * (br_b @ wb) + gates[:, :, 2] * (br_c @ wc)
    y = merged @ w_out
    x = x + gate_m[:, None] * rmsnorm(y, g_mix_post)

    h2 = rmsnorm(x, g_ff_pre) * (1.0 + scale_f[:, None]) + shift_f[:, None]
    y2 = jnp.square(jax.nn.relu(h2 @ w_ff1)) @ w_ff2
    return x + gate_f[:, None] * rmsnorm(y2, g_ff_post)


def setup_inputs(seed: int = 0) -> dict:
    key = jax.random.key(seed)
    ks = jax.random.split(key, 20)

    def nrm(k, shape, std):
        return jax.random.normal(k, shape, jnp.float32) * std

    d = D_MODEL
    branch_row_scale = jnp.concatenate([
        jnp.full((A_WIDTH,), A_WIDTH ** -0.5, jnp.float32),
        jnp.full((POOL_WIDTH,), POOL_WIDTH ** -0.5, jnp.float32),
        jnp.full((CONV_WIDTH,), CONV_WIDTH ** -0.5, jnp.float32)])
    return {
        'x': nrm(ks[0], (BATCH, SEQ, d), 1.0),
        'c': nrm(ks[1], (BATCH, d), 1.0),
        'w_ada': nrm(ks[2], (DEPTH, d, 6 * d), 0.5 * d ** -0.5),
        'b_ada': nrm(ks[3], (DEPTH, 6 * d), 0.02),
        'g_mix_pre': 1.0 + nrm(ks[4], (DEPTH, d), 0.05),
        'g_mix_post': 1.0 + nrm(ks[5], (DEPTH, d), 0.05),
        'g_ff_pre': 1.0 + nrm(ks[6], (DEPTH, d), 0.05),
        'g_ff_post': 1.0 + nrm(ks[7], (DEPTH, d), 0.05),
        'w_in': nrm(ks[8], (DEPTH, d, IN_COLS), d ** -0.5),
        'b_f': 3.0 + nrm(ks[9], (DEPTH, A_HEADS), 0.1),
        'w_pool': nrm(ks[10], (DEPTH, POOL_GROUPS, POOL_GROUP_DIM, POOL_GROUP_DIM), POOL_GROUP_DIM ** -0.5),
        'pool_scale': 1.0 + nrm(ks[11], (DEPTH, POOL_WIDTH), 0.1),
        'conv_w': nrm(ks[12], (DEPTH, CONV_K, CONV_WIDTH), CONV_K ** -0.5),
        'w_branch': nrm(ks[13], (DEPTH, MIX_WIDTH, d), 1.0) * branch_row_scale[None, :, None],
        'w_out': nrm(ks[14], (DEPTH, d, d), d ** -0.5),
        'w_ff1': nrm(ks[15], (DEPTH, d, D_FF), d ** -0.5),
        'w_ff2': nrm(ks[16], (DEPTH, D_FF, d), D_FF ** -0.5),
    }


def reference(x, c, w_ada, b_ada, g_mix_pre, g_mix_post, g_ff_pre, g_ff_post, w_in, b_f,
              w_pool, pool_scale, conv_w, w_branch, w_out, w_ff1, w_ff2):
    for l in range(DEPTH):
        x = hybrid_layer(x, c, w_ada[l], b_ada[l], g_mix_pre[l], g_mix_post[l], g_ff_pre[l], g_ff_post[l],
                         w_in[l], b_f[l], w_pool[l], pool_scale[l], conv_w[l], w_branch[l], w_out[l],
                         w_ff1[l], w_ff2[l])
    return x
```

```cpp
#include <hip/hip_runtime.h>
#include <cstdint>
#include <cstdio>

constexpr int D = 1024, NB = 8, S = 2048, DEPTH = 2, T = NB * S;
constexpr int AW = 512, PW = 256, CW = 256, INC = 5640, FF = 4096;
constexpr int ZQ = 0, ZK = 512, ZV = 1024, ZF = 1536, ZPU = 1544, ZCH = 1800, ZCB = 2056, ZCC = 2312, ZGL = 2568;

__global__ void k_mod(const float* c, const float* w_ada, const float* b_ada, float* mod) {
    const int j = blockIdx.x * 256 + threadIdx.x, b = blockIdx.y, l = blockIdx.z;
    const float* W = w_ada + (size_t)l * D * 6 * D;
    float acc = b_ada[l * 6 * D + j];
    for (int k = 0; k < D; ++k) { const float v = c[b * D + k]; const float sv = v / (1.f + expf(-v)); acc += sv * W[(size_t)k * 6 * D + j]; }
    mod[((size_t)l * NB + b) * 6 * D + j] = acc;
}

__device__ __forceinline__ float block_sum256(float v, float* red) {
    for (int o = 32; o > 0; o >>= 1) v += __shfl_xor(v, o);
    __syncthreads();
    if ((threadIdx.x & 63) == 0) red[threadIdx.x >> 6] = v;
    __syncthreads();
    return red[0] + red[1] + red[2] + red[3];
}

__global__ void k_rmsmod(const float* x, const float* g, const float* scale, const float* shift, float* out) {
    __shared__ float red[4];
    const int t = blockIdx.x; const float* xr = x + (size_t)t * D; float v[4]; float ss = 0.f;
    for (int i = 0; i < 4; ++i) { v[i] = xr[threadIdx.x + 256 * i]; ss += v[i] * v[i]; }
    ss = block_sum256(ss, red);
    const float r = rsqrtf(ss / D + 1e-6f);
    for (int i = 0; i < 4; ++i) { const int j = threadIdx.x + 256 * i; out[(size_t)t * D + j] = v[i] * r * g[j] * (1.f + scale[j]) + shift[j]; }
}
__global__ void k_resnorm(const float* base, const float* y, const float* g, const float* gate, float* out) {
    __shared__ float red[4];
    const int t = blockIdx.x; const float* yr = y + (size_t)t * D; float v[4]; float ss = 0.f;
    for (int i = 0; i < 4; ++i) { v[i] = yr[threadIdx.x + 256 * i]; ss += v[i] * v[i]; }
    ss = block_sum256(ss, red);
    const float r = rsqrtf(ss / D + 1e-6f);
    for (int i = 0; i < 4; ++i) { const int j = threadIdx.x + 256 * i; out[(size_t)t * D + j] = base[(size_t)t * D + j] + gate[j] * (v[i] * r * g[j]); }
}

template <int EPI> __global__ void k_sgemm(const float* A, int lda, const float* B, int ldb, float* C, int ldc, int M, int N, int K) {
    __shared__ float sA[16][64 + 4], sB[16][64 + 4];
    const int tx = threadIdx.x & 15, ty = threadIdx.x >> 4; const int m0 = blockIdx.y * 64, n0 = blockIdx.x * 64;
    float acc[4][4] = {};
    for (int k0 = 0; k0 < K; k0 += 16) {
        for (int e = threadIdx.x; e < 64 * 16; e += 256) { const int r = e >> 4, kk = e & 15; sA[kk][r] = A[(size_t)(m0 + r) * lda + k0 + kk]; }
        for (int e = threadIdx.x; e < 64 * 16; e += 256) { const int kk = e >> 6, cidx = e & 63; sB[kk][cidx] = (n0 + cidx < N) ? B[(size_t)(k0 + kk) * ldb + n0 + cidx] : 0.f; }
        __syncthreads();
#pragma unroll
        for (int kk = 0; kk < 16; ++kk) { float a[4], b[4];
#pragma unroll
            for (int i = 0; i < 4; ++i) { a[i] = sA[kk][ty * 4 + i]; b[i] = sB[kk][tx * 4 + i]; }
#pragma unroll
            for (int i = 0; i < 4; ++i)
#pragma unroll
                for (int j = 0; j < 4; ++j) acc[i][j] += a[i] * b[j]; }
        __syncthreads();
    }
    for (int i = 0; i < 4; ++i) for (int j = 0; j < 4; ++j) { const int r = m0 + ty * 4 + i, cc = n0 + tx * 4 + j; if (cc < N) { float v = acc[i][j]; if (EPI == 1) { v = v > 0.f ? v * v : 0.f; } C[(size_t)r * ldc + cc] = v; } }
}

__global__ void k_cumf(const float* z, const float* b_f, float* cumF) {
    __shared__ float lf[S];
    const int h = blockIdx.x;
    for (int s = threadIdx.x; s < S; s += blockDim.x) { const float v = z[(size_t)s * INC + ZF + h] + b_f[h]; lf[s] = fminf(v, 0.f) - log1pf(expf(-fabsf(v))); }
    __syncthreads();
    if (threadIdx.x == 0) { float a = 0.f; for (int s = 0; s < S; ++s) { a += lf[s]; lf[s] = a; } }
    __syncthreads();
    for (int s = threadIdx.x; s < S; s += blockDim.x) cumF[h * S + s] = lf[s];
}

__global__ void k_attn(const float* z, const float* cumF, float* out) {
    __shared__ float sp[4][S]; __shared__ float sq[4][64];
    const int w = threadIdx.x >> 6, lane = threadIdx.x & 63, t = blockIdx.x * 4 + w, h = blockIdx.y;
    sq[w][lane] = z[(size_t)t * INC + ZQ + h * 64 + lane];
    __syncthreads();
    const float Ft = cumF[h * S + t]; float mx = -1e30f;
    for (int s = lane; s <= t; s += 64) { const float* kr = z + (size_t)s * INC + ZK + h * 64; float a = 0.f; for (int d = 0; d < 64; ++d) a += sq[w][d] * kr[d];
        const float lg = a * 0.125f + Ft - cumF[h * S + s]; sp[w][s] = lg; mx = fmaxf(mx, lg); }
    for (int o = 32; o > 0; o >>= 1) mx = fmaxf(mx, __shfl_xor(mx, o));
    float sum = 0.f;
    for (int s = lane; s <= t; s += 64) { const float e = expf(sp[w][s] - mx); sp[w][s] = e; sum += e; }
    for (int o = 32; o > 0; o >>= 1) sum += __shfl_xor(sum, o);
    __syncthreads();
    float o = 0.f;
    for (int s = 0; s <= t; ++s) o += sp[w][s] * z[(size_t)s * INC + ZV + h * 64 + lane];
    out[(size_t)t * AW + h * 64 + lane] = o / sum;
}

__global__ void k_pool_p(const float* z, float* p) {
    const int idx = blockIdx.x * 256 + threadIdx.x; const int t = idx / PW, c = idx % PW; const int g = c / 64; const int w = 2 << g;
    float s = 0.f; int cnt = 0;
    for (int j = 0; j < w; ++j) if (t - j >= 0) { s += z[(size_t)(t - j) * INC + ZPU + c]; ++cnt; }
    p[idx] = s / (float)cnt - z[(size_t)t * INC + ZPU + c];
}
__global__ void k_pool_mm(const float* p, const float* w_pool, const float* pool_scale, float* out) {
    const int idx = blockIdx.x * 256 + threadIdx.x; const int t = idx / PW, c = idx % PW; const int g = c / 64, d = c % 64;
    float a = 0.f; for (int k = 0; k < 64; ++k) a += p[(size_t)t * PW + g * 64 + k] * w_pool[(g * 64 + k) * 64 + d];
    out[idx] = a * pool_scale[c];
}
__global__ void k_conv(const float* z, const float* conv_w, float* out) {
    const int idx = blockIdx.x * 256 + threadIdx.x; const int t = idx / CW, c = idx % CW;
    float y = 0.f;
    for (int j = 0; j < 3; ++j) { const int tt = t - 2 + j; if (tt >= 0) y += conv_w[j * CW + c] * (z[(size_t)tt * INC + ZCC + c] * z[(size_t)tt * INC + ZCH + c]); }
    out[idx] = z[(size_t)t * INC + ZCB + c] * y;
}
__global__ void k_merge(const float* z, const float* Pa, const float* Pb, const float* Pc, float* merged) {
    const int idx = blockIdx.x * 256 + threadIdx.x; const int t = idx / D, j = idx % D;
    const float g0 = 1.f / (1.f + expf(-z[(size_t)t * INC + ZGL + j])), g1 = 1.f / (1.f + expf(-z[(size_t)t * INC + ZGL + D + j])), g2 = 1.f / (1.f + expf(-z[(size_t)t * INC + ZGL + 2 * D + j]));
    merged[idx] = g0 * Pa[idx] + g1 * Pb[idx] + g2 * Pc[idx];
}

extern "C" void kernel_launch(void* const* d_in, const int* in_sizes, int n_in, void* d_out, int out_size, void* d_ws, size_t ws_size, hipStream_t stream) {
    const float* x = (const float*)d_in[0]; const float* c = (const float*)d_in[1]; const float* w_ada = (const float*)d_in[2]; const float* b_ada = (const float*)d_in[3];
    const float* g_mix_pre = (const float*)d_in[4]; const float* g_mix_post = (const float*)d_in[5]; const float* g_ff_pre = (const float*)d_in[6]; const float* g_ff_post = (const float*)d_in[7];
    const float* w_in = (const float*)d_in[8]; const float* b_f = (const float*)d_in[9]; const float* w_pool = (const float*)d_in[10]; const float* pool_scale = (const float*)d_in[11];
    const float* conv_w = (const float*)d_in[12]; const float* w_branch = (const float*)d_in[13]; const float* w_out = (const float*)d_in[14]; const float* w_ff1 = (const float*)d_in[15]; const float* w_ff2 = (const float*)d_in[16];
    float* out = (float*)d_out;
    float* ws = (float*)d_ws; size_t off = 0;
    auto take = [&](size_t n) { float* p = ws + off; off += (n + 63) / 64 * 64; return p; };
    float* mod = take((size_t)DEPTH * NB * 6 * D);
    float* xmid = take((size_t)T * D);
    float* h = take((size_t)S * D);
    float* z = take((size_t)S * INC);
    float* cumF = take(8 * S);
    float* brA = take((size_t)S * AW); float* pp = take((size_t)S * PW); float* brB = take((size_t)S * PW); float* brC = take((size_t)S * CW);
    float* Pa = take((size_t)S * D); float* Pb = take((size_t)S * D); float* Pc = take((size_t)S * D);
    float* merged = take((size_t)S * D); float* y = take((size_t)S * D); float* x1 = take((size_t)S * D);
    float* a = take((size_t)S * FF);
    if (off * 4 > ws_size) { fprintf(stderr, "ws too small\n"); return; }
    k_mod<<<dim3(6 * D / 256, NB, DEPTH), 256, 0, stream>>>(c, w_ada, b_ada, mod);
    for (int l = 0; l < DEPTH; ++l) {
        const float* xin = l == 0 ? x : xmid; float* xout = l == DEPTH - 1 ? out : xmid;
        const float* Win = w_in + (size_t)l * D * INC; const float* Wbr = w_branch + (size_t)l * D * D; const float* Wo = w_out + (size_t)l * D * D;
        const float* W1 = w_ff1 + (size_t)l * D * FF; const float* W2 = w_ff2 + (size_t)l * FF * D;
        for (int b = 0; b < NB; ++b) {
            const float* m = mod + ((size_t)l * NB + b) * 6 * D; const float* xb = xin + (size_t)b * S * D; float* ob = xout + (size_t)b * S * D;
            k_rmsmod<<<S, 256, 0, stream>>>(xb, g_mix_pre + l * D, m + D, m, h);
            k_sgemm<0><<<dim3((INC + 63) / 64, S / 64), 256, 0, stream>>>(h, D, Win, INC, z, INC, S, INC, D);
            k_cumf<<<8, 256, 0, stream>>>(z, b_f + l * 8, cumF);
            k_attn<<<dim3(S / 4, 8), 256, 0, stream>>>(z, cumF, brA);
            k_pool_p<<<S * PW / 256, 256, 0, stream>>>(z, pp);
            k_pool_mm<<<S * PW / 256, 256, 0, stream>>>(pp, w_pool + (size_t)l * 4 * 64 * 64, pool_scale + l * PW, brB);
            k_conv<<<S * CW / 256, 256, 0, stream>>>(z, conv_w + (size_t)l * 3 * CW, brC);
            k_sgemm<0><<<dim3(D / 64, S / 64), 256, 0, stream>>>(brA, AW, Wbr, D, Pa, D, S, D, AW);
            k_sgemm<0><<<dim3(D / 64, S / 64), 256, 0, stream>>>(brB, PW, Wbr + (size_t)AW * D, D, Pb, D, S, D, PW);
            k_sgemm<0><<<dim3(D / 64, S / 64), 256, 0, stream>>>(brC, CW, Wbr + (size_t)(AW + PW) * D, D, Pc, D, S, D, CW);
            k_merge<<<S * D / 256, 256, 0, stream>>>(z, Pa, Pb, Pc, merged);
            k_sgemm<0><<<dim3(D / 64, S / 64), 256, 0, stream>>>(merged, D, Wo, D, y, D, S, D, D);
            k_resnorm<<<S, 256, 0, stream>>>(xb, y, g_mix_post + l * D, m + 2 * D, x1);
            k_rmsmod<<<S, 256, 0, stream>>>(x1, g_ff_pre + l * D, m + 4 * D, m + 3 * D, h);
            k_sgemm<1><<<dim3(FF / 64, S / 64), 256, 0, stream>>>(h, D, W1, FF, a, FF, S, FF, D);
            k_sgemm<0><<<dim3(D / 64, S / 64), 256, 0, stream>>>(a, FF, W2, D, y, D, S, D, FF);
            k_resnorm<<<S, 256, 0, stream>>>(x1, y, g_ff_post + l * D, m + 5 * D, ob);
        }
    }
}
```
